# Optimizing an MI355X kernel written in HIP

```python
import math
import jax, jax.numpy as jnp
from jax import lax
import numpy as np

D_MODEL = 1024
BATCH = 16
SEQ = 256
DEPTH = 1
DEC_BATCH = 2
DEC_SEQ = 2048
PAST_LEN = 256

GRID_W = 64
MIX_WIDTH = D_MODEL
ATT_WIDTH = MIX_WIDTH // 2
SSM_WIDTH = MIX_WIDTH - ATT_WIDTH
HEAD_DIM = 64
N_ATT_HEADS = ATT_WIDTH // (2 * HEAD_DIM)
SSM_GROUP = 16
N_SSM_GROUPS = SSM_WIDTH // SSM_GROUP
SSM_STATE = 64
IN_WIDTH = 3 * ATT_WIDTH + SSM_WIDTH
D_FF = -(-8 * D_MODEL // (3 * 256)) * 256
N_MOD = 6
Q_BLOCK = 128
ROPE_BASE = 10000.0
NORM_EPS = 1e-6

kernel_name = "hybrid_diffattn_s5_prefix_dit_step"


def rmsnorm(x, g):
    xf = x.astype(jnp.float32)
    y = xf * lax.rsqrt(jnp.mean(xf * xf, axis=-1, keepdims=True) + NORM_EPS)
    return (y * g.astype(jnp.float32)).astype(x.dtype)


def modulation(cond, w_mod, b_mod, dtype):
    m = jax.nn.silu(cond.astype(jnp.float32)) @ w_mod.astype(jnp.float32) + b_mod.astype(jnp.float32)
    return [t.astype(dtype) for t in jnp.split(m[:, None, :], N_MOD, axis=-1)]


def axial_rope_tables(n_rows):
    t = jnp.arange(n_rows * GRID_W)
    row = (t // GRID_W).astype(jnp.float32)
    col = (t % GRID_W).astype(jnp.float32)
    half = HEAD_DIM // 2
    inv_freq = ROPE_BASE ** (-jnp.arange(0, half, 2, dtype=jnp.float32) / half)
    ang_r = row[:, None] * inv_freq
    ang_c = col[:, None] * inv_freq
    ang = jnp.concatenate([ang_r, ang_r, ang_c, ang_c], axis=-1)
    return jnp.cos(ang), jnp.sin(ang)


def rotate_half_axial(x):
    x1, x2, x3, x4 = jnp.split(x, 4, axis=-1)
    return jnp.concatenate([-x2, x1, -x4, x3], axis=-1)


def apply_rope(x, cos, sin):
    c = cos[None, :, None, None, :]
    s = sin[None, :, None, None, :]
    xf = x.astype(jnp.float32)
    return (xf * c + rotate_half_axial(xf) * s).astype(x.dtype)


def diff_attention(q, k, v, lam, subln_g, lam_init):
    b, lq = q.shape[:2]
    nb = lq // Q_BLOCK
    scale = HEAD_DIM ** -0.5
    qb = q.reshape(b, nb, Q_BLOCK, N_ATT_HEADS, 2, HEAD_DIM).transpose(1, 0, 2, 3, 4, 5)
    vf = v.astype(jnp.float32)

    def one_block(q_blk):
        s = jnp.einsum('bqhmd,bkhmd->bhmqk', q_blk, k,
                       preferred_element_type=jnp.float32) * scale
        p = jax.nn.softmax(s, axis=-1)
        w = p[:, :, 0] - lam * p[:, :, 1]
        return jnp.einsum('bhqk,bkhe->bqhe', w, vf)

    o = lax.map(one_block, qb)
    o = o.transpose(1, 0, 2, 3, 4).reshape(b, lq, N_ATT_HEADS, 2 * HEAD_DIM)
    o = rmsnorm(o, subln_g) * (1.0 - lam_init)
    return o.reshape(b, lq, ATT_WIDTH)


def _complex_affine_combine(e1, e2):
    a1r, a1i, b1r, b1i = e1
    a2r, a2i, b2r, b2i = e2
    return (a2r * a1r - a2i * a1i,
            a2r * a1i + a2i * a1r,
            a2r * b1r - a2i * b1i + b2r,
            a2r * b1i + a2i * b1r + b2i)


def s5_bidirectional(u, lam_re, lam_im, log_step, b_re, b_im, c_re, c_im, d_skip, h0_re, h0_im):
    bsz, L = u.shape[:2]
    uf = u.astype(jnp.float32).reshape(bsz, L, N_SSM_GROUPS, SSM_GROUP)
    ys, hr, hi = [], [], []
    for dr in range(2):
        lr = jnp.minimum(lam_re[dr].astype(jnp.float32), -1e-4)
        li = lam_im[dr].astype(jnp.float32)
        step = jnp.exp(log_step[dr].astype(jnp.float32))[:, None]
        mag = jnp.exp(lr * step)
        ab_re = mag * jnp.cos(li * step)
        ab_im = mag * jnp.sin(li * step)
        den = lr * lr + li * li
        nr = ab_re - 1.0
        f_re = (nr * lr + ab_im * li) / den
        f_im = (ab_im * lr - nr * li) / den
        br = b_re[dr].astype(jnp.float32)
        bi = b_im[dr].astype(jnp.float32)
        bb_re = f_re[:, :, None] * br - f_im[:, :, None] * bi
        bb_im = f_re[:, :, None] * bi + f_im[:, :, None] * br
        bu_re = jnp.einsum('blgc,gpc->blgp', uf, bb_re)
        bu_im = jnp.einsum('blgc,gpc->blgp', uf, bb_im)
        reverse = dr == 1
        edge = -1 if reverse else 0
        h0r = h0_re[:, dr].astype(jnp.float32)
        h0i = h0_im[:, dr].astype(jnp.float32)
        bu_re = bu_re.at[:, edge].add(ab_re * h0r - ab_im * h0i)
        bu_im = bu_im.at[:, edge].add(ab_re * h0i + ab_im * h0r)
        a_re = jnp.broadcast_to(ab_re, bu_re.shape)
        a_im = jnp.broadcast_to(ab_im, bu_im.shape)
        _, _, h_re, h_im = lax.associative_scan(
            _complex_affine_combine, (a_re, a_im, bu_re, bu_im), axis=1, reverse=reverse)
        y = (jnp.einsum('blgp,gcp->blgc', h_re, c_re[dr].astype(jnp.float32))
             - jnp.einsum('blgp,gcp->blgc', h_im, c_im[dr].astype(jnp.float32)))
        ys.append(y.reshape(bsz, L, SSM_WIDTH)
                  + d_skip[dr].astype(jnp.float32) * uf.reshape(bsz, L, SSM_WIDTH))
        last = 0 if reverse else -1
        hr.append(h_re[:, last])
        hi.append(h_im[:, last])
    return ys[0] + ys[1], jnp.stack(hr, axis=1), jnp.stack(hi, axis=1)


def layer_forward(x, cond, lp, lam_init, rope, ctx_k, ctx_v, h0_re, h0_im):
    shift1, scale1, gate1, shift2, scale2, gate2 = modulation(cond, lp['w_mod'], lp['b_mod'], x.dtype)
    g = lp['norm_g']
    bsz, L = x.shape[:2]
    h = rmsnorm(x, g[0]) * (1 + scale1) + shift1
    proj = h @ lp['w_in']
    q = proj[..., :ATT_WIDTH].reshape(bsz, L, N_ATT_HEADS, 2, HEAD_DIM)
    k = proj[..., ATT_WIDTH:2 * ATT_WIDTH].reshape(bsz, L, N_ATT_HEADS, 2, HEAD_DIM)
    v = proj[..., 2 * ATT_WIDTH:3 * ATT_WIDTH].reshape(bsz, L, N_ATT_HEADS, 2 * HEAD_DIM)
    u = proj[..., 3 * ATT_WIDTH:]
    keys, vals, q_in = k, v, q
    if rope is not None:
        q_in = apply_rope(q, *rope)
        keys = apply_rope(k, *rope)
    if ctx_k is not None:
        keys = jnp.concatenate([ctx_k.astype(keys.dtype), keys], axis=1)
        vals = jnp.concatenate([ctx_v.astype(vals.dtype), vals], axis=1)
    lp_lam = lp['lam'].astype(jnp.float32)
    lam = (jnp.exp(jnp.sum(lp_lam[0] * lp_lam[1])) - jnp.exp(jnp.sum(lp_lam[2] * lp_lam[3]))
           + lam_init)
    attn = diff_attention(q_in, keys, vals, lam, lp['subln_g'], lam_init)
    y_ssm, hf_re, hf_im = s5_bidirectional(
        u, lp['lam_re'], lp['lam_im'], lp['log_step'], lp['b_re'], lp['b_im'],
        lp['c_re'], lp['c_im'], lp['d_skip'], h0_re, h0_im)
    z = jax.nn.gelu(y_ssm)
    z = z * jax.nn.sigmoid(z @ lp['w_glu'].astype(jnp.float32) + lp['b_glu'].astype(jnp.float32))
    mix = jnp.concatenate([attn, z], axis=-1).astype(x.dtype) @ lp['w_o']
    x = x + gate1 * rmsnorm(mix, g[1])
    h = rmsnorm(x, g[2]) * (1 + scale2) + shift2
    gt, up = jnp.split(h @ lp['w_ffn_in'], 2, axis=-1)
    f = (jax.nn.silu(gt) * up) @ lp['w_ffn_out']
    x = x + gate2 * rmsnorm(f, g[3])
    return x, k, v, hf_re, hf_im


def setup_inputs(seed: int = 0) -> dict:
    key = jax.random.key(seed)
    ks = jax.random.split(key, 32)
    f32 = jnp.float32

    def nrm(k, shape, scale):
        return scale * jax.random.normal(k, shape, f32)

    G, P = N_SSM_GROUPS, SSM_STATE
    n = jnp.arange(P, dtype=f32)
    return {
        'x_prompt': nrm(ks[0], (BATCH, SEQ, D_MODEL), 1.0),
        'x_sample': nrm(ks[1], (DEC_BATCH, DEC_SEQ, D_MODEL), 1.0),
        'cache_k': nrm(ks[2], (DEC_BATCH, DEPTH, PAST_LEN, 2 * N_ATT_HEADS, HEAD_DIM), 1.0),
        'cache_v': nrm(ks[3], (DEC_BATCH, DEPTH, PAST_LEN, N_ATT_HEADS, 2 * HEAD_DIM), 1.0),
        'state_ssm_re': nrm(ks[4], (DEC_BATCH, DEPTH, 2, G, P), 0.1),
        'state_ssm_im': nrm(ks[5], (DEC_BATCH, DEPTH, 2, G, P), 0.1),
        'c': nrm(ks[6], (DEC_BATCH, D_MODEL), 1.0),
        'c_ctx': nrm(ks[7], (D_MODEL,), 1.0),
        'w_mod': nrm(ks[8], (DEPTH, D_MODEL, N_MOD * D_MODEL), 0.5 * D_MODEL ** -0.5),
        'b_mod': nrm(ks[9], (DEPTH, N_MOD * D_MODEL), 0.01),
        'norm_g': 1.0 + nrm(ks[10], (DEPTH, 4, D_MODEL), 0.01),
        'w_in': nrm(ks[11], (DEPTH, D_MODEL, IN_WIDTH), D_MODEL ** -0.5),
        'lam_params': nrm(ks[12], (DEPTH, 4, HEAD_DIM), 0.1),
        'subln_g': 1.0 + nrm(ks[13], (DEPTH, 2 * HEAD_DIM), 0.01),
        'ssm_lambda_re': -0.5 + nrm(ks[14], (DEPTH, 2, G, P), 0.01),
        'ssm_lambda_im': math.pi * n + nrm(ks[15], (DEPTH, 2, G, P), 0.01),
        'ssm_log_step': jax.random.uniform(ks[16], (DEPTH, 2, G), f32,
                                           math.log(1e-3), math.log(1e-1)),
        'ssm_b_re': nrm(ks[17], (DEPTH, 2, G, P, SSM_GROUP), (2 * SSM_GROUP) ** -0.5),
        'ssm_b_im': nrm(ks[18], (DEPTH, 2, G, P, SSM_GROUP), (2 * SSM_GROUP) ** -0.5),
        'ssm_c_re': nrm(ks[19], (DEPTH, 2, G, SSM_GROUP, P), (2 * P) ** -0.5),
        'ssm_c_im': nrm(ks[20], (DEPTH, 2, G, SSM_GROUP, P), (2 * P) ** -0.5),
        'ssm_d': nrm(ks[21], (DEPTH, 2, SSM_WIDTH), 0.5),
        'w_glu': nrm(ks[22], (DEPTH, SSM_WIDTH, SSM_WIDTH), SSM_WIDTH ** -0.5),
        'b_glu': nrm(ks[23], (DEPTH, SSM_WIDTH), 0.01),
        'w_o': nrm(ks[24], (DEPTH, MIX_WIDTH, D_MODEL), MIX_WIDTH ** -0.5),
        'w_ffn_in': nrm(ks[25], (DEPTH, D_MODEL, 2 * D_FF), D_MODEL ** -0.5),
        'w_ffn_out': nrm(ks[26], (DEPTH, D_FF, D_MODEL), D_FF ** -0.5),
    }


def reference(x_prompt, x_sample, cache_k, cache_v, state_ssm_re, state_ssm_im, c, c_ctx,
              w_mod, b_mod, norm_g, w_in, lam_params, subln_g,
              ssm_lambda_re, ssm_lambda_im, ssm_log_step, ssm_b_re, ssm_b_im,
              ssm_c_re, ssm_c_im, ssm_d, w_glu, b_glu, w_o, w_ffn_in, w_ffn_out):
    n_rows = x_sample.shape[1] // GRID_W
    rope = axial_rope_tables(n_rows)
    bp, lp_len = x_prompt.shape[:2]
    bd, past = cache_k.shape[0], cache_k.shape[2]
    zeros_h = jnp.zeros((bp, 2, N_SSM_GROUPS, SSM_STATE), jnp.float32)
    xp, xs = x_prompt, x_sample
    ks_out, vs_out, hr_out, hi_out = [], [], [], []
    for l in range(DEPTH):
        lam_init = 0.8 - 0.6 * math.exp(-0.3 * l)
        lp = {
            'w_mod': w_mod[l], 'b_mod': b_mod[l], 'norm_g': norm_g[l], 'w_in': w_in[l],
            'lam': lam_params[l], 'subln_g': subln_g[l],
            'lam_re': ssm_lambda_re[l], 'lam_im': ssm_lambda_im[l], 'log_step': ssm_log_step[l],
            'b_re': ssm_b_re[l], 'b_im': ssm_b_im[l], 'c_re': ssm_c_re[l], 'c_im': ssm_c_im[l],
            'd_skip': ssm_d[l], 'w_glu': w_glu[l], 'b_glu': b_glu[l], 'w_o': w_o[l],
            'w_ffn_in': w_ffn_in[l], 'w_ffn_out': w_ffn_out[l],
        }
        xp, k_ctx, v_ctx, h_re, h_im = layer_forward(
            xp, c_ctx[None, :], lp, lam_init, None, None, None, zeros_h, zeros_h)
        ks_out.append(k_ctx.reshape(bp, lp_len, 2 * N_ATT_HEADS, HEAD_DIM))
        vs_out.append(v_ctx)
        hr_out.append(h_re)
        hi_out.append(h_im)
        ck = cache_k[:, l].reshape(bd, past, N_ATT_HEADS, 2, HEAD_DIM)
        cv = cache_v[:, l]
        xs, _, _, _, _ = layer_forward(
            xs, c, lp, lam_init, rope, ck, cv, state_ssm_re[:, l], state_ssm_im[:, l])
    new_cache_k = jnp.stack(ks_out, axis=1)
    new_cache_v = jnp.stack(vs_out, axis=1)
    new_state_ssm_re = jnp.stack(hr_out, axis=1)
    new_state_ssm_im = jnp.stack(hi_out, axis=1)
    return (xp, xs, new_cache_k, new_cache_v, new_state_ssm_re, new_state_ssm_im)
```

```cpp
#include <hip/hip_runtime.h>
#include <cstdint>
#include <cstdio>

namespace {
constexpr int D = 1024, NPR = 4096, NSR = 4096, M = NPR + NSR;
constexpr int SEQ_P = 256, SEQ_S = 2048, PAST = 256, NB_P = 16, NB_S = 2;
constexpr int INW = 2048, AW = 512, SW = 512, HD = 64, NH = 4, G = 32, P = 64, C = 16, DFF = 2816, NMOD = 6;
constexpr float EPS = 1e-6f, LAM_INIT = 0.2f;

__device__ __forceinline__ float wave_sum(float v) {
#pragma unroll
    for (int o = 1; o < 64; o <<= 1) v += __shfl_xor(v, o);
    return v;
}
__device__ __forceinline__ float wave_max(float v) {
#pragma unroll
    for (int o = 1; o < 64; o <<= 1) v = fmaxf(v, __shfl_xor(v, o));
    return v;
}
__device__ __forceinline__ float silu_f(float x) { return x / (1.f + expf(-x)); }
__device__ __forceinline__ float sigmoid_f(float x) { return 1.f / (1.f + expf(-x)); }
__device__ __forceinline__ float gelu_tanh_f(float x) { return 0.5f * x * (1.f + tanhf(0.7978845608028654f * (x + 0.044715f * x * x * x))); }
__device__ __forceinline__ int cond_of_row(int row) { return row < NPR ? 0 : 1 + (row - NPR) / SEQ_S; }

__global__ void __launch_bounds__(256) k_mod(const float* c, const float* c_ctx, const float* w_mod, const float* b_mod, float* mod) {
    __shared__ float sc[3][D];
    for (int i = threadIdx.x; i < D; i += 256) { sc[0][i] = silu_f(c_ctx[i]); sc[1][i] = silu_f(c[i]); sc[2][i] = silu_f(c[D + i]); }
    __syncthreads();
    const int j = blockIdx.x * 256 + threadIdx.x;
    if (j >= NMOD * D) return;
    float a0 = 0.f, a1 = 0.f, a2 = 0.f;
    for (int k = 0; k < D; ++k) { const float w = w_mod[(size_t)k * (NMOD * D) + j]; a0 += sc[0][k] * w; a1 += sc[1][k] * w; a2 += sc[2][k] * w; }
    const float b = b_mod[j];
    mod[j] = a0 + b; mod[NMOD * D + j] = a1 + b; mod[2 * NMOD * D + j] = a2 + b;
}

__global__ void __launch_bounds__(256) k_norm_mod(const float* xp, const float* xs, const float* g, const float* mod, int shift_idx, int scale_idx, float* out) {
    const int row = blockIdx.x * 4 + (threadIdx.x >> 6), lane = threadIdx.x & 63;
    const float* x = row < NPR ? xp + (size_t)row * D : xs + (size_t)(row - NPR) * D;
    const float* mc = mod + cond_of_row(row) * NMOD * D;
    float v[16]; float s = 0.f;
#pragma unroll
    for (int i = 0; i < 16; ++i) { v[i] = x[lane + 64 * i]; s += v[i] * v[i]; }
    const float r = rsqrtf(wave_sum(s) * (1.f / D) + EPS);
#pragma unroll
    for (int i = 0; i < 16; ++i) { const int col = lane + 64 * i; out[(size_t)row * D + col] = v[i] * r * g[col] * (1.f + mc[scale_idx * D + col]) + mc[shift_idx * D + col]; }
}

template <int MODE>
__global__ void __launch_bounds__(256) k_gemm(const float* A, int lda, const float* W, int ldw, float* Cc, int ldc, int K, int N) {
    __shared__ float As[16][65], Ws[16][64], Wu[MODE == 1 ? 16 : 1][64];
    const int tx = threadIdx.x & 15, ty = threadIdx.x >> 4, m0 = blockIdx.y * 64, n0 = blockIdx.x * 64;
    float acc[4][4] = {}, acu[4][4] = {};
    for (int k0 = 0; k0 < K; k0 += 16) {
        for (int i = threadIdx.x; i < 64 * 16; i += 256) { const int r = i >> 4, kk = i & 15; As[kk][r] = A[(size_t)(m0 + r) * lda + k0 + kk]; }
        for (int i = threadIdx.x; i < 16 * 64; i += 256) { const int kk = i >> 6, cc = i & 63; Ws[kk][cc] = W[(size_t)(k0 + kk) * ldw + n0 + cc]; if (MODE == 1) Wu[kk][cc] = W[(size_t)(k0 + kk) * ldw + N + n0 + cc]; }
        __syncthreads();
#pragma unroll
        for (int kk = 0; kk < 16; ++kk) {
            float a[4], b[4], bu[4];
#pragma unroll
            for (int i = 0; i < 4; ++i) { a[i] = As[kk][ty * 4 + i]; b[i] = Ws[kk][tx * 4 + i]; if (MODE == 1) bu[i] = Wu[kk][tx * 4 + i]; }
#pragma unroll
            for (int i = 0; i < 4; ++i)
#pragma unroll
                for (int j = 0; j < 4; ++j) { acc[i][j] += a[i] * b[j]; if (MODE == 1) acu[i][j] += a[i] * bu[j]; }
        }
        __syncthreads();
    }
#pragma unroll
    for (int i = 0; i < 4; ++i)
#pragma unroll
        for (int j = 0; j < 4; ++j) {
            float v = acc[i][j]; if (MODE == 1) v = silu_f(v) * acu[i][j];
            Cc[(size_t)(m0 + ty * 4 + i) * ldc + n0 + tx * 4 + j] = v;
        }
}

__global__ void __launch_bounds__(256) k_kvout(const float* proj, float* ok, float* ov) {
    const int i = blockIdx.x * 256 + threadIdx.x;
    const int row = i >> 9, col = i & 511;
    ok[i] = proj[(size_t)row * INW + AW + col];
    ov[i] = proj[(size_t)row * INW + 2 * AW + col];
}

__global__ void __launch_bounds__(256) k_rope(float* proj) {
    const int i = blockIdx.x * 256 + threadIdx.x;
    const int fi = i & 15, axis = (i >> 4) & 1, hm = (i >> 5) & 7, qk = (i >> 8) & 1, rs = i >> 9;
    const int pos = rs % SEQ_S; const int prow = pos / 64, pcol = pos % 64;
    const float inv = exp2f(-(float)fi * (13.287712379549449f / 16.f));
    const float ang = (float)(axis == 0 ? prow : pcol) * inv;
    const float cs = cosf(ang), sn = sinf(ang);
    float* base = proj + (size_t)(NPR + rs) * INW + qk * AW + hm * HD + axis * 32 + fi;
    const float lo = base[0], hi = base[16];
    base[0] = lo * cs - hi * sn; base[16] = hi * cs + lo * sn;
}

__global__ void __launch_bounds__(256) k_attn(const float* proj, const float* cache_k, const float* cache_v, const float* lam_p, const float* subln_g, float* mixin) {
    __shared__ float qs[4][128];
    const int w = threadIdx.x >> 6, lane = threadIdx.x & 63;
    const int item = blockIdx.x * 4 + w; const int row = item >> 2, h = item & 3;
    const float lam = expf(wave_sum(lam_p[lane] * lam_p[64 + lane])) - expf(wave_sum(lam_p[128 + lane] * lam_p[192 + lane])) + LAM_INIT;
    qs[w][lane] = proj[(size_t)row * INW + h * 128 + lane]; qs[w][64 + lane] = proj[(size_t)row * INW + h * 128 + 64 + lane];
    __syncthreads();
    const bool smp = row >= NPR; const int b = smp ? (row - NPR) / SEQ_S : row / SEQ_P;
    const int ntile = smp ? (PAST + SEQ_S) / 64 : SEQ_P / 64;
    const int rowbase = smp ? NPR + b * SEQ_S : b * SEQ_P;
    float m0 = -INFINITY, m1 = -INFINITY, l0 = 0.f, l1 = 0.f, o0a = 0.f, o0b = 0.f, o1a = 0.f, o1b = 0.f;
    for (int t = 0; t < ntile; ++t) {
        const float* kp; const float* vp; int ks, vs;
        if (smp && t < 4) { kp = cache_k + (size_t)(b * PAST + t * 64) * 512 + h * 128; vp = cache_v + (size_t)(b * PAST + t * 64) * 512 + h * 128; ks = 512; vs = 512; }
        else { const int r0 = rowbase + (smp ? (t - 4) * 64 : t * 64); kp = proj + (size_t)r0 * INW + AW + h * 128; vp = proj + (size_t)r0 * INW + 2 * AW + h * 128; ks = INW; vs = INW; }
        const float* kr = kp + (size_t)lane * ks;
        float s0 = 0.f, s1 = 0.f;
        for (int d = 0; d < 64; ++d) { s0 += qs[w][d] * kr[d]; s1 += qs[w][64 + d] * kr[64 + d]; }
        s0 *= 0.125f; s1 *= 0.125f;
        const float n0 = fmaxf(m0, wave_max(s0)), n1 = fmaxf(m1, wave_max(s1));
        const float c0 = expf(m0 - n0), c1 = expf(m1 - n1);
        const float p0 = expf(s0 - n0), p1 = expf(s1 - n1);
        l0 = l0 * c0 + wave_sum(p0); l1 = l1 * c1 + wave_sum(p1);
        o0a *= c0; o0b *= c0; o1a *= c1; o1b *= c1; m0 = n0; m1 = n1;
        for (int j = 0; j < 64; ++j) {
            const float pj0 = __shfl(p0, j), pj1 = __shfl(p1, j);
            const float va = vp[(size_t)j * vs + lane], vb = vp[(size_t)j * vs + 64 + lane];
            o0a += pj0 * va; o0b += pj0 * vb; o1a += pj1 * va; o1b += pj1 * vb;
        }
    }
    const float oa = o0a / l0 - lam * (o1a / l1), ob = o0b / l0 - lam * (o1b / l1);
    const float r = rsqrtf(wave_sum(oa * oa + ob * ob) * (1.f / 128.f) + EPS) * (1.f - LAM_INIT);
    mixin[(size_t)row * D + h * 128 + lane] = oa * r * subln_g[lane];
    mixin[(size_t)row * D + h * 128 + 64 + lane] = ob * r * subln_g[64 + lane];
}

__global__ void __launch_bounds__(256) k_ssm(const float* proj, const float* lam_re, const float* lam_im, const float* log_step, const float* b_re, const float* b_im,
                                              const float* c_re, const float* c_im, const float* d_skip, const float* st_re, const float* st_im, float* y, float* out_re, float* out_im) {
    __shared__ float red[4][16][65];
    const int w = threadIdx.x >> 6, lane = threadIdx.x & 63;
    const int item = blockIdx.x * 4 + w; const int bb = item / G, g = item % G;
    const bool smp = bb >= NB_P; const int b = smp ? bb - NB_P : bb;
    const int L = smp ? SEQ_S : SEQ_P, rowbase = smp ? NPR + b * SEQ_S : b * SEQ_P;
    for (int dr = 0; dr < 2; ++dr) {
        const int gp = (dr * G + g) * P + lane;
        const double lr = fmin((double)lam_re[gp], -1e-4), li = (double)lam_im[gp], step = exp((double)log_step[dr * G + g]);
        const double mag = exp(lr * step), ar = mag * cos(li * step), ai = mag * sin(li * step);
        const double den = lr * lr + li * li, nr = ar - 1.0, fr = (nr * lr + ai * li) / den, fi = (ai * lr - nr * li) / den;
        float bbr[C], bbi[C], cr[C], ci[C];
#pragma unroll
        for (int c = 0; c < C; ++c) {
            const double br = (double)b_re[(size_t)gp * C + c], bi = (double)b_im[(size_t)gp * C + c];
            bbr[c] = (float)(fr * br - fi * bi); bbi[c] = (float)(fr * bi + fi * br);
            cr[c] = c_re[((size_t)(dr * G + g) * C + c) * P + lane]; ci[c] = c_im[((size_t)(dr * G + g) * C + c) * P + lane];
        }
        const float a_r = (float)ar, a_i = (float)ai;
        float hr = 0.f, hi = 0.f;
        if (smp) { hr = st_re[((size_t)(b * 2 + dr) * G + g) * P + lane]; hi = st_im[((size_t)(b * 2 + dr) * G + g) * P + lane]; }
        for (int s = 0; s < L; ++s) {
            const int t = dr == 0 ? s : L - 1 - s; const int row = rowbase + t;
            const float* up = proj + (size_t)row * INW + 3 * AW + g * C;
            float bur = 0.f, bui = 0.f, uu[C];
#pragma unroll
            for (int c = 0; c < C; ++c) { uu[c] = up[c]; bur += bbr[c] * uu[c]; bui += bbi[c] * uu[c]; }
            const float nhr = a_r * hr - a_i * hi + bur, nhi = a_r * hi + a_i * hr + bui; hr = nhr; hi = nhi;
#pragma unroll
            for (int c = 0; c < C; ++c) red[w][c][lane] = hr * cr[c] - hi * ci[c];
            __builtin_amdgcn_wave_barrier();
            const int c = lane >> 2, q = lane & 3; float sum = 0.f;
#pragma unroll
            for (int i = 0; i < 16; ++i) sum += red[w][c][q * 16 + i];
            sum += __shfl_xor(sum, 1); sum += __shfl_xor(sum, 2);
            __builtin_amdgcn_wave_barrier();
            if (q == 0) {
                float* yp = y + (size_t)row * SW + g * C + c;
                if (dr == 0) *yp = sum + (d_skip[g * C + c] + d_skip[SW + g * C + c]) * up[c]; else *yp += sum;
            }
        }
        if (!smp) { out_re[((size_t)(b * 2 + dr) * G + g) * P + lane] = hr; out_im[((size_t)(b * 2 + dr) * G + g) * P + lane] = hi; }
    }
}

__global__ void __launch_bounds__(256) k_gelu(const float* y, float* z) { const int i = blockIdx.x * 256 + threadIdx.x; z[i] = gelu_tanh_f(y[i]); }
__global__ void __launch_bounds__(256) k_glu(const float* z, const float* gl, const float* b_glu, float* mixin) {
    const int i = blockIdx.x * 256 + threadIdx.x; const int row = i >> 9, col = i & 511;
    mixin[(size_t)row * D + AW + col] = z[i] * sigmoid_f(gl[i] + b_glu[col]);
}

__global__ void __launch_bounds__(256) k_rowpass2(const float* xp, const float* xs, const float* mix, const float* norm_g, const float* mod, float* x1, float* h2) {
    const int row = blockIdx.x * 4 + (threadIdx.x >> 6), lane = threadIdx.x & 63;
    const float* x = row < NPR ? xp + (size_t)row * D : xs + (size_t)(row - NPR) * D;
    const float* mc = mod + cond_of_row(row) * NMOD * D;
    float v[16], mv[16]; float s = 0.f;
#pragma unroll
    for (int i = 0; i < 16; ++i) { mv[i] = mix[(size_t)row * D + lane + 64 * i]; s += mv[i] * mv[i]; }
    const float r1 = rsqrtf(wave_sum(s) * (1.f / D) + EPS); s = 0.f;
#pragma unroll
    for (int i = 0; i < 16; ++i) { const int col = lane + 64 * i; v[i] = x[col] + mc[2 * D + col] * (mv[i] * r1 * norm_g[D + col]); s += v[i] * v[i]; x1[(size_t)row * D + col] = v[i]; }
    const float r2 = rsqrtf(wave_sum(s) * (1.f / D) + EPS);
#pragma unroll
    for (int i = 0; i < 16; ++i) { const int col = lane + 64 * i; h2[(size_t)row * D + col] = v[i] * r2 * norm_g[2 * D + col] * (1.f + mc[4 * D + col]) + mc[3 * D + col]; }
}
__global__ void __launch_bounds__(256) k_rowpass3(const float* x1, const float* f, const float* norm_g, const float* mod, float* out) {
    const int row = blockIdx.x * 4 + (threadIdx.x >> 6), lane = threadIdx.x & 63;
    const float* mc = mod + cond_of_row(row) * NMOD * D;
    float fv[16]; float s = 0.f;
#pragma unroll
    for (int i = 0; i < 16; ++i) { fv[i] = f[(size_t)row * D + lane + 64 * i]; s += fv[i] * fv[i]; }
    const float r = rsqrtf(wave_sum(s) * (1.f / D) + EPS);
#pragma unroll
    for (int i = 0; i < 16; ++i) { const int col = lane + 64 * i; out[(size_t)row * D + col] = x1[(size_t)row * D + col] + mc[5 * D + col] * (fv[i] * r * norm_g[3 * D + col]); }
}
}

extern "C" void kernel_launch(void* const* d_in, const int* in_sizes, int n_in, void* d_out, int out_size, void* d_ws, size_t ws_size, hipStream_t stream) {
    const float* x_prompt = (const float*)d_in[0]; const float* x_sample = (const float*)d_in[1];
    const float* cache_k = (const float*)d_in[2]; const float* cache_v = (const float*)d_in[3];
    const float* st_re = (const float*)d_in[4]; const float* st_im = (const float*)d_in[5];
    const float* c = (const float*)d_in[6]; const float* c_ctx = (const float*)d_in[7];
    const float* w_mod = (const float*)d_in[8]; const float* b_mod = (const float*)d_in[9]; const float* norm_g = (const float*)d_in[10];
    const float* w_in = (const float*)d_in[11]; const float* lam_p = (const float*)d_in[12]; const float* subln_g = (const float*)d_in[13];
    const float* s_lre = (const float*)d_in[14]; const float* s_lim = (const float*)d_in[15]; const float* s_step = (const float*)d_in[16];
    const float* s_bre = (const float*)d_in[17]; const float* s_bim = (const float*)d_in[18]; const float* s_cre = (const float*)d_in[19]; const float* s_cim = (const float*)d_in[20];
    const float* s_d = (const float*)d_in[21]; const float* w_glu = (const float*)d_in[22]; const float* b_glu = (const float*)d_in[23];
    const float* w_o = (const float*)d_in[24]; const float* w_ffn_in = (const float*)d_in[25]; const float* w_ffn_out = (const float*)d_in[26];
    float* out = (float*)d_out;
    float* o_y = out; float* o_k = out + (size_t)M * D; float* o_v = o_k + (size_t)NPR * 512; float* o_sre = o_v + (size_t)NPR * 512; float* o_sim = o_sre + NB_P * 2 * G * P;
    float* ws = (float*)d_ws;
    float* mod = ws;
    float* h1 = ws + 32768;
    float* proj = h1 + (size_t)M * D;
    float* mixin = proj + (size_t)M * INW;
    float* yssm = mixin + (size_t)M * D;
    float* zb = yssm + (size_t)M * SW;
    float* mix = zb + (size_t)M * SW;
    float* x1 = mix + (size_t)M * D;
    float* act = proj;

    k_mod<<<NMOD * D / 256, 256, 0, stream>>>(c, c_ctx, w_mod, b_mod, mod);
    k_norm_mod<<<M / 4, 256, 0, stream>>>(x_prompt, x_sample, norm_g, mod, 0, 1, h1);
    k_gemm<0><<<dim3(INW / 64, M / 64), 256, 0, stream>>>(h1, D, w_in, INW, proj, INW, D, INW);
    k_kvout<<<NPR * 512 / 256, 256, 0, stream>>>(proj, o_k, o_v);
    k_rope<<<NSR * 512 / 256, 256, 0, stream>>>(proj);
    k_attn<<<M * NH / 4, 256, 0, stream>>>(proj, cache_k, cache_v, lam_p, subln_g, mixin);
    k_ssm<<<(NB_P + NB_S) * G / 4, 256, 0, stream>>>(proj, s_lre, s_lim, s_step, s_bre, s_bim, s_cre, s_cim, s_d, st_re, st_im, yssm, o_sre, o_sim);
    k_gelu<<<M * SW / 256, 256, 0, stream>>>(yssm, zb);
    k_gemm<0><<<dim3(SW / 64, M / 64), 256, 0, stream>>>(zb, SW, w_glu, SW, yssm, SW, SW, SW);
    k_glu<<<M * SW / 256, 256, 0, stream>>>(zb, yssm, b_glu, mixin);
    k_gemm<0><<<dim3(D / 64, M / 64), 256, 0, stream>>>(mixin, D, w_o, D, mix, D, D, D);
    k_rowpass2<<<M / 4, 256, 0, stream>>>(x_prompt, x_sample, mix, norm_g, mod, x1, h1);
    k_gemm<1><<<dim3(DFF / 64, M / 64), 256, 0, stream>>>(h1, D, w_ffn_in, 2 * DFF, act, DFF, D, DFF);
    k_gemm<0><<<dim3(D / 64, M / 64), 256, 0, stream>>>(act, DFF, w_ffn_out, D, mix, D, DFF, D);
    k_rowpass3<<<M / 4, 256, 0, stream>>>(x1, mix, norm_g, mod, o_y);
}
```
